# Optimizing an MI355X kernel written in HIP

```python
import math
import jax, jax.numpy as jnp
from jax import lax
import numpy as np

D_MODEL = 1024
BATCH = 4
SEQ = 4096
DEPTH = 2

CHUNK = 64
Q_BLOCK = 128
NUM_BUCKETS = 32
MAX_DISTANCE = 128
EPS = 1e-6
NEG = -1e30

A_HEADS = 4
A_HEAD_DIM = 64
A_V_DIM = 2 * A_HEAD_DIM
B_HEADS = 8
B_HEAD_DIM = 64
IDX_HEADS = 8
IDX_DIM = 32
TOPK_MAX = 256
N_ATTN_HEADS = A_HEADS + B_HEADS

ATTN_SPLITS = (
    2 * A_HEADS * A_HEAD_DIM,
    2 * A_HEADS * A_HEAD_DIM,
    A_HEADS * A_V_DIM,
    B_HEADS * B_HEAD_DIM,
    B_HEAD_DIM,
    B_HEAD_DIM,
    IDX_HEADS * IDX_DIM,
    IDX_DIM,
    IDX_HEADS,
)
ATTN_IN = sum(ATTN_SPLITS)
ATTN_MIX = A_HEADS * A_V_DIM + B_HEADS * B_HEAD_DIM

CONV_CH = 512
CONV_WIDTH = 31
SC_CH = 512
SC_WIDTH = 3
CONV_IN = 2 * CONV_CH + 3 * SC_CH
CONV_MIX = CONV_CH + SC_CH

D_FF = 4 * D_MODEL
N_EVEN = (DEPTH + 1) // 2
N_ODD = DEPTH // 2

kernel_name = 'hybrid_chunk_causal_diff_dsa_conv_block'


def rms_norm(x, g):
    xf = x.astype(jnp.float32)
    y = xf * lax.rsqrt(jnp.mean(xf * xf, axis=-1, keepdims=True) + EPS)
    return (y * g.astype(jnp.float32)).astype(x.dtype)


def layer_norm(x, g, b):
    xf = x.astype(jnp.float32)
    mu = jnp.mean(xf, axis=-1, keepdims=True)
    var = jnp.mean(jnp.square(xf - mu), axis=-1, keepdims=True)
    y = (xf - mu) * lax.rsqrt(var + EPS)
    return (y * g.astype(jnp.float32) + b.astype(jnp.float32)).astype(x.dtype)


def t5_bucket(rel):
    nb = NUM_BUCKETS // 2
    ret = jnp.where(rel > 0, nb, 0)
    n = jnp.abs(rel)
    max_exact = nb // 2
    nf = jnp.maximum(n, 1).astype(jnp.float32)
    large = max_exact + (jnp.log(nf / max_exact) / math.log(MAX_DISTANCE / max_exact)
                         * (nb - max_exact)).astype(jnp.int32)
    large = jnp.minimum(large, nb - 1)
    return ret + jnp.where(n < max_exact, n, large)


def admissible(q_pos, k_pos):
    return (k_pos // CHUNK) <= (q_pos // CHUNK)


def to_blocks(t, nblk):
    return t.reshape(t.shape[0], nblk, Q_BLOCK, *t.shape[2:]).swapaxes(0, 1)


def from_blocks(t):
    t = t.swapaxes(0, 1)
    return t.reshape(t.shape[0], t.shape[1] * t.shape[2], *t.shape[3:])


def diff_attention(q1, q2, k1, k2, v, bias_tab, lam, subln_g, lambda_init):
    S = q1.shape[1]
    nblk = S // Q_BLOCK
    k_pos = jnp.arange(S)
    scale = A_HEAD_DIM ** -0.5

    def one_block(args):
        qb1, qb2, blk = args
        q_pos = blk * Q_BLOCK + jnp.arange(Q_BLOCK)
        rel = k_pos[None, :] - q_pos[:, None]
        bias = bias_tab[t5_bucket(rel)].astype(jnp.float32).transpose(2, 0, 1)
        mask = admissible(q_pos[:, None], k_pos[None, :])

        def probs(q, k):
            s = jnp.einsum('bqhd,bkhd->bhqk', q, k).astype(jnp.float32) * scale + bias
            return jax.nn.softmax(jnp.where(mask, s, NEG), axis=-1)

        a = probs(qb1, k1) - lam * probs(qb2, k2)
        return jnp.einsum('bhqk,bkhd->bqhd', a.astype(v.dtype), v)

    out = from_blocks(lax.map(one_block, (to_blocks(q1, nblk), to_blocks(q2, nblk), jnp.arange(nblk))))
    out = rms_norm(out, subln_g) * (1.0 - lambda_init)
    return out.reshape(out.shape[0], S, -1)


def dsa_attention(q, qi, wi, k, v, ki, bias_tab, top_k):
    S = q.shape[1]
    nblk = S // Q_BLOCK
    k_pos = jnp.arange(S)
    scale = B_HEAD_DIM ** -0.5
    idx_scale = IDX_DIM ** -0.5
    w_scale = IDX_HEADS ** -0.5

    def one_block(args):
        qb, qib, wib, blk = args
        q_pos = blk * Q_BLOCK + jnp.arange(Q_BLOCK)
        mask = admissible(q_pos[:, None], k_pos[None, :])
        idx_logits = jnp.einsum('bqhd,bkd->bhqk', qib, ki).astype(jnp.float32) * idx_scale
        score = jnp.einsum('bhqk,bqh->bqk', jax.nn.relu(idx_logits),
                           wib.astype(jnp.float32) * w_scale)
        score = jnp.where(mask[None], score, -jnp.inf)
        top_val, top_idx = lax.top_k(score, top_k)
        valid = jnp.isfinite(top_val)
        k_sel = jax.vmap(lambda kb, ib: kb[ib])(k, top_idx)
        v_sel = jax.vmap(lambda vb, ib: vb[ib])(v, top_idx)
        rel = top_idx - q_pos[None, :, None]
        bias = bias_tab[t5_bucket(rel)].astype(jnp.float32).transpose(0, 3, 1, 2)
        s = jnp.einsum('bqhd,bqkd->bhqk', qb, k_sel).astype(jnp.float32) * scale + bias
        p = jax.nn.softmax(jnp.where(valid[:, None], s, NEG), axis=-1)
        return jnp.einsum('bhqk,bqkd->bqhd', p.astype(v_sel.dtype), v_sel)

    out = from_blocks(lax.map(one_block, (to_blocks(q, nblk), to_blocks(qi, nblk),
                                          to_blocks(wi, nblk), jnp.arange(nblk))))
    return out.reshape(out.shape[0], S, -1)


def attention_mixer(h, w_in, w_out, rel_bias, lam_vecs, subln_g, layer_idx, top_k):
    Bsz, S, _ = h.shape
    proj = h @ w_in
    offs = np.cumsum(ATTN_SPLITS)[:-1].tolist()
    aq, ak, av, bq, bk, bv, iq, ik, iw = jnp.split(proj, offs, axis=-1)
    aq = aq.reshape(Bsz, S, A_HEADS, 2, A_HEAD_DIM)
    ak = ak.reshape(Bsz, S, A_HEADS, 2, A_HEAD_DIM)
    av = av.reshape(Bsz, S, A_HEADS, A_V_DIM)
    lambda_init = 0.8 - 0.6 * math.exp(-0.3 * layer_idx)
    lv = lam_vecs.astype(jnp.float32)
    lam = jnp.exp(jnp.sum(lv[0] * lv[1])) - jnp.exp(jnp.sum(lv[2] * lv[3])) + lambda_init
    ya = diff_attention(aq[..., 0, :], aq[..., 1, :], ak[..., 0, :], ak[..., 1, :], av,
                        rel_bias[:, :A_HEADS], lam, subln_g, lambda_init)
    yb = dsa_attention(bq.reshape(Bsz, S, B_HEADS, B_HEAD_DIM),
                       iq.reshape(Bsz, S, IDX_HEADS, IDX_DIM), iw, bk, bv, ik,
                       rel_bias[:, A_HEADS:], top_k)
    return jnp.concatenate([ya, yb], axis=-1) @ w_out


def depthwise_causal_conv(u, w):
    W, C = w.shape
    return lax.conv_general_dilated(u, w[:, None, :].astype(u.dtype), window_strides=(1,),
                                    padding=[(W - 1, 0)],
                                    dimension_numbers=('NWC', 'WIO', 'NWC'),
                                    feature_group_count=C)


def conv_mixer(h, w_in, w_out, dw_w, dw_b, ln_g, ln_b, sc_w):
    proj = h @ w_in
    ca, cg, db, dc, dh = jnp.split(
        proj, [CONV_CH, 2 * CONV_CH, 2 * CONV_CH + SC_CH, 2 * CONV_CH + 2 * SC_CH], axis=-1)
    u = ca * jax.nn.sigmoid(cg)
    u = depthwise_causal_conv(u, dw_w) + dw_b.astype(u.dtype)
    u = jax.nn.silu(layer_norm(u, ln_g, ln_b))
    z = db * depthwise_causal_conv(dc * dh, sc_w)
    return jnp.concatenate([u, z], axis=-1) @ w_out


def setup_inputs(seed: int = 0) -> dict:
    key = jax.random.key(seed)
    ks = jax.random.split(key, 20)
    f32 = jnp.float32
    nrm = lambda k, shape, s: jax.random.normal(k, shape, f32) * s
    return {
        'x': nrm(ks[0], (BATCH, SEQ, D_MODEL), 1.0),
        'rel_bias': nrm(ks[1], (NUM_BUCKETS, N_ATTN_HEADS), 0.5),
        'norm_g': 1.0 + nrm(ks[2], (DEPTH, 4, D_MODEL), 0.05),
        'w_mlp_up': nrm(ks[3], (DEPTH, D_MODEL, D_FF), D_MODEL ** -0.5),
        'w_mlp_down': nrm(ks[4], (DEPTH, D_FF, D_MODEL), D_FF ** -0.5),
        'attn_w_in': nrm(ks[5], (N_EVEN, D_MODEL, ATTN_IN), D_MODEL ** -0.5),
        'attn_w_out': nrm(ks[6], (N_EVEN, ATTN_MIX, D_MODEL), ATTN_MIX ** -0.5),
        'diff_lambda': nrm(ks[7], (N_EVEN, 4, A_HEAD_DIM), 0.1),
        'diff_subln_g': 1.0 + nrm(ks[8], (N_EVEN, A_V_DIM), 0.05),
        'conv_w_in': nrm(ks[9], (N_ODD, D_MODEL, CONV_IN), D_MODEL ** -0.5),
        'conv_w_out': nrm(ks[10], (N_ODD, CONV_MIX, D_MODEL), CONV_MIX ** -0.5),
        'conv_dw_w': nrm(ks[11], (N_ODD, CONV_WIDTH, CONV_CH), CONV_WIDTH ** -0.5),
        'conv_dw_b': nrm(ks[12], (N_ODD, CONV_CH), 0.02),
        'conv_ln_g': 1.0 + nrm(ks[13], (N_ODD, CONV_CH), 0.05),
        'conv_ln_b': nrm(ks[14], (N_ODD, CONV_CH), 0.02),
        'sconv_w': nrm(ks[15], (N_ODD, SC_WIDTH, SC_CH), SC_WIDTH ** -0.5),
    }


def reference(x, rel_bias, norm_g, w_mlp_up, w_mlp_down, attn_w_in, attn_w_out, diff_lambda,
              diff_subln_g, conv_w_in, conv_w_out, conv_dw_w, conv_dw_b, conv_ln_g, conv_ln_b,
              sconv_w):
    top_k = min(TOPK_MAX, x.shape[1] // 4)
    for i in range(DEPTH):
        j = i // 2
        h = rms_norm(x, norm_g[i, 0])
        if i % 2 == 0:
            m = attention_mixer(h, attn_w_in[j], attn_w_out[j], rel_bias, diff_lambda[j],
                                diff_subln_g[j], i, top_k)
        else:
            m = conv_mixer(h, conv_w_in[j], conv_w_out[j], conv_dw_w[j], conv_dw_b[j],
                           conv_ln_g[j], conv_ln_b[j], sconv_w[j])
        x = x + rms_norm(m, norm_g[i, 1])
        h = rms_norm(x, norm_g[i, 2])
        u = jax.nn.relu(h @ w_mlp_up[i])
        x = x + rms_norm((u * u) @ w_mlp_down[i], norm_g[i, 3])
    return x
```

```cpp
#include <hip/hip_runtime.h>
#include <cstdio>
#include <cstdint>

namespace v0 {
constexpr int NB = 4, S = 4096, D = 1024, M = NB * S, FF = 4096;
constexpr int ATT_IN = 2472, CONV_IN = 2560;
constexpr float EPS = 1e-6f;

__device__ __forceinline__ float wave_sum(float v) {
#pragma unroll
    for (int o = 1; o < 64; o <<= 1) v += __shfl_xor(v, o);
    return v;
}
__device__ __forceinline__ float wave_max(float v) {
#pragma unroll
    for (int o = 1; o < 64; o <<= 1) v = fmaxf(v, __shfl_xor(v, o));
    return v;
}
__device__ __forceinline__ float block_sum(float v, float* red) {
    v = wave_sum(v);
    __syncthreads();
    if ((threadIdx.x & 63) == 0) red[threadIdx.x >> 6] = v;
    __syncthreads();
    float t = 0.f;
    const int nw = blockDim.x >> 6;
    for (int i = 0; i < nw; ++i) t += red[i];
    return t;
}
__device__ __forceinline__ float block_max(float v, float* red) {
    v = wave_max(v);
    __syncthreads();
    if ((threadIdx.x & 63) == 0) red[threadIdx.x >> 6] = v;
    __syncthreads();
    float t = red[0];
    const int nw = blockDim.x >> 6;
    for (int i = 1; i < nw; ++i) t = fmaxf(t, red[i]);
    return t;
}
__device__ __forceinline__ int block_sum_i(int v, int* red) {
#pragma unroll
    for (int o = 1; o < 64; o <<= 1) v += __shfl_xor(v, o);
    __syncthreads();
    if ((threadIdx.x & 63) == 0) red[threadIdx.x >> 6] = v;
    __syncthreads();
    int t = 0;
    const int nw = blockDim.x >> 6;
    for (int i = 0; i < nw; ++i) t += red[i];
    return t;
}

__device__ __forceinline__ int t5_bucket(int rel) {
    const int ret = rel > 0 ? 16 : 0;
    const int n = rel < 0 ? -rel : rel;
    if (n < 8) return ret + n;
    int large;
    if (n < 12) large = 8; else if (n < 16) large = 9; else if (n < 23) large = 10; else if (n < 32) large = 11;
    else if (n < 46) large = 12; else if (n < 64) large = 13; else if (n < 91) large = 14; else large = 15;
    return ret + large;
}

__global__ void __launch_bounds__(256) k_rmsnorm(const float* __restrict__ x, const float* __restrict__ g, float* __restrict__ out) {
    const int row = blockIdx.x * 4 + (threadIdx.x >> 6), lane = threadIdx.x & 63;
    const float4* xr = (const float4*)(x + (size_t)row * D);
    const float4* gr = (const float4*)g;
    float4 v[4]; float s = 0.f;
#pragma unroll
    for (int j = 0; j < 4; ++j) { v[j] = xr[lane + 64 * j]; s += v[j].x * v[j].x + v[j].y * v[j].y + v[j].z * v[j].z + v[j].w * v[j].w; }
    s = wave_sum(s);
    const float r = rsqrtf(s * (1.f / D) + EPS);
    float4* o = (float4*)(out + (size_t)row * D);
#pragma unroll
    for (int j = 0; j < 4; ++j) { const float4 gg = gr[lane + 64 * j]; float4 w; w.x = v[j].x * r * gg.x; w.y = v[j].y * r * gg.y; w.z = v[j].z * r * gg.z; w.w = v[j].w * r * gg.w; o[lane + 64 * j] = w; }
}
__global__ void __launch_bounds__(256) k_addnorm(const float* base, const float* __restrict__ mix, const float* __restrict__ g, float* out) {
    const int row = blockIdx.x * 4 + (threadIdx.x >> 6), lane = threadIdx.x & 63;
    const float4* xr = (const float4*)(mix + (size_t)row * D);
    const float4* br = (const float4*)(base + (size_t)row * D);
    const float4* gr = (const float4*)g;
    float4 v[4]; float s = 0.f;
#pragma unroll
    for (int j = 0; j < 4; ++j) { v[j] = xr[lane + 64 * j]; s += v[j].x * v[j].x + v[j].y * v[j].y + v[j].z * v[j].z + v[j].w * v[j].w; }
    s = wave_sum(s);
    const float r = rsqrtf(s * (1.f / D) + EPS);
    float4* o = (float4*)(out + (size_t)row * D);
#pragma unroll
    for (int j = 0; j < 4; ++j) { const float4 gg = gr[lane + 64 * j]; const float4 bb = br[lane + 64 * j]; float4 w;
        w.x = bb.x + v[j].x * r * gg.x; w.y = bb.y + v[j].y * r * gg.y; w.z = bb.z + v[j].z * r * gg.z; w.w = bb.w + v[j].w * r * gg.w; o[lane + 64 * j] = w; }
}

template <int ACT>
__global__ void __launch_bounds__(256) k_gemm(const float* __restrict__ A, const float* __restrict__ Bm, float* __restrict__ C, int N, int K) {
    __shared__ float As[16][132];
    __shared__ float Bs[16][132];
    const int tid = threadIdx.x, bm = blockIdx.y * 128, bn = blockIdx.x * 128, ty = tid >> 4, tx = tid & 15;
    float acc[8][8];
#pragma unroll
    for (int i = 0; i < 8; ++i)
#pragma unroll
        for (int j = 0; j < 8; ++j) acc[i][j] = 0.f;
    for (int k0 = 0; k0 < K; k0 += 16) {
#pragma unroll
        for (int i = 0; i < 2; ++i) {
            const int row = (tid >> 2) + 64 * i, kq = (tid & 3) * 4;
            const float4 v = *(const float4*)(A + (size_t)(bm + row) * K + k0 + kq);
            As[kq + 0][row] = v.x; As[kq + 1][row] = v.y; As[kq + 2][row] = v.z; As[kq + 3][row] = v.w;
        }
#pragma unroll
        for (int i = 0; i < 2; ++i) {
            const int k = (tid >> 5) + 8 * i, n = bn + (tid & 31) * 4;
            float4 v = make_float4(0.f, 0.f, 0.f, 0.f);
            if (n < N) v = *(const float4*)(Bm + (size_t)(k0 + k) * N + n);
            *(float4*)&Bs[k][(tid & 31) * 4] = v;
        }
        __syncthreads();
#pragma unroll
        for (int k = 0; k < 16; ++k) {
            const float4 a0 = *(const float4*)&As[k][ty * 8], a1 = *(const float4*)&As[k][ty * 8 + 4];
            const float4 b0 = *(const float4*)&Bs[k][tx * 8], b1 = *(const float4*)&Bs[k][tx * 8 + 4];
            const float a[8] = {a0.x, a0.y, a0.z, a0.w, a1.x, a1.y, a1.z, a1.w};
            const float b[8] = {b0.x, b0.y, b0.z, b0.w, b1.x, b1.y, b1.z, b1.w};
#pragma unroll
            for (int i = 0; i < 8; ++i)
#pragma unroll
                for (int j = 0; j < 8; ++j) acc[i][j] = fmaf(a[i], b[j], acc[i][j]);
        }
        __syncthreads();
    }
#pragma unroll
    for (int i = 0; i < 8; ++i) {
        float* crow = C + (size_t)(bm + ty * 8 + i) * N;
#pragma unroll
        for (int j4 = 0; j4 < 2; ++j4) {
            const int n = bn + tx * 8 + j4 * 4;
            if (n < N) {
                float4 v = make_float4(acc[i][j4 * 4 + 0], acc[i][j4 * 4 + 1], acc[i][j4 * 4 + 2], acc[i][j4 * 4 + 3]);
                if (ACT == 1) { v.x = fmaxf(v.x, 0.f); v.y = fmaxf(v.y, 0.f); v.z = fmaxf(v.z, 0.f); v.w = fmaxf(v.w, 0.f); v.x *= v.x; v.y *= v.y; v.z *= v.z; v.w *= v.w; }
                *(float4*)(crow + n) = v;
            }
        }
    }
}

__global__ void __launch_bounds__(256) k_diff_attn(const float* __restrict__ proj, const float* __restrict__ rel_bias, const float* __restrict__ lamv,
                                                   const float* __restrict__ subg, float* __restrict__ Y) {
    __shared__ float s1[S];
    __shared__ float s2[S];
    __shared__ float qs[128];
    __shared__ float red[8];
    __shared__ float part[256];
    const int i = blockIdx.x, h = blockIdx.y, b = blockIdx.z, tid = threadIdx.x;
    const float* prow = proj + (size_t)(b * S + i) * ATT_IN;
    if (tid < 128) qs[tid] = prow[h * 128 + tid];
    float la = (tid < 64) ? lamv[tid] * lamv[64 + tid] : 0.f;
    float lb = (tid < 64) ? lamv[128 + tid] * lamv[192 + tid] : 0.f;
    la = block_sum(la, red);
    lb = block_sum(lb, red);
    const float lam = expf(la) - expf(lb) + 0.2f;
    __syncthreads();
    const int N = (i / 64 + 1) * 64;
    for (int j = tid; j < N; j += 256) {
        const float4* kr = (const float4*)(proj + (size_t)(b * S + j) * ATT_IN + 512 + h * 128);
        float d1 = 0.f, d2 = 0.f;
#pragma unroll
        for (int c = 0; c < 16; ++c) { const float4 kv = kr[c]; d1 += qs[4 * c] * kv.x + qs[4 * c + 1] * kv.y + qs[4 * c + 2] * kv.z + qs[4 * c + 3] * kv.w; }
#pragma unroll
        for (int c = 0; c < 16; ++c) { const float4 kv = kr[16 + c]; d2 += qs[64 + 4 * c] * kv.x + qs[64 + 4 * c + 1] * kv.y + qs[64 + 4 * c + 2] * kv.z + qs[64 + 4 * c + 3] * kv.w; }
        const float bias = rel_bias[t5_bucket(j - i) * 12 + h];
        s1[j] = d1 * 0.125f + bias; s2[j] = d2 * 0.125f + bias;
    }
    __syncthreads();
    float m1 = -1e30f, m2 = -1e30f;
    for (int j = tid; j < N; j += 256) { m1 = fmaxf(m1, s1[j]); m2 = fmaxf(m2, s2[j]); }
    m1 = block_max(m1, red); m2 = block_max(m2, red);
    float l1 = 0.f, l2 = 0.f;
    for (int j = tid; j < N; j += 256) { const float e1 = expf(s1[j] - m1), e2 = expf(s2[j] - m2); s1[j] = e1; s2[j] = e2; l1 += e1; l2 += e2; }
    l1 = block_sum(l1, red); l2 = block_sum(l2, red);
    const float r1 = 1.f / l1, r2 = lam / l2;
    for (int j = tid; j < N; j += 256) s1[j] = s1[j] * r1 - s2[j] * r2;
    __syncthreads();
    const int d = tid & 127, half = tid >> 7;
    float acc = 0.f;
    const float* vb = proj + (size_t)(b * S) * ATT_IN + 1024 + h * 128 + d;
    for (int j = half; j < N; j += 2) acc += s1[j] * vb[(size_t)j * ATT_IN];
    part[tid] = acc;
    __syncthreads();
    const float o = part[d] + part[128 + d];
    float sq = (tid < 128) ? o * o : 0.f;
    sq = block_sum(sq, red);
    if (tid < 128) Y[(size_t)(b * S + i) * D + h * 128 + d] = o * rsqrtf(sq * (1.f / 128.f) + EPS) * subg[d] * 0.8f;
}

__device__ __forceinline__ unsigned f2key(float f) { const unsigned u = __float_as_uint(f); return (u & 0x80000000u) ? ~u : (u | 0x80000000u); }

__global__ void __launch_bounds__(256) k_dsa(const float* __restrict__ proj, const float* __restrict__ rel_bias, float* __restrict__ Y) {
    __shared__ unsigned key[S];
    __shared__ float qi[256];
    __shared__ float wi[8];
    __shared__ float q[512];
    __shared__ int sel[256];
    __shared__ float p[8][256];
    __shared__ int redi[8];
    __shared__ float red[8];
    __shared__ int cnt;
    const int i = blockIdx.x, b = blockIdx.y, tid = threadIdx.x;
    const float* prow = proj + (size_t)(b * S + i) * ATT_IN;
    qi[tid] = prow[2176 + tid];
    if (tid < 8) wi[tid] = prow[2464 + tid] * 0.35355339059327373f;
    q[tid] = prow[1536 + tid]; q[256 + tid] = prow[1536 + 256 + tid];
    if (tid == 0) cnt = 0;
    __syncthreads();
    const int N = (i / 64 + 1) * 64;
    const int K = N < 256 ? N : 256;
    for (int j = tid; j < N; j += 256) {
        const float4* kr = (const float4*)(proj + (size_t)(b * S + j) * ATT_IN + 2432);
        float ds[8];
#pragma unroll
        for (int hh = 0; hh < 8; ++hh) ds[hh] = 0.f;
#pragma unroll 1
        for (int c = 0; c < 8; ++c) {
            const float4 kv = kr[c];
#pragma unroll
            for (int hh = 0; hh < 8; ++hh) ds[hh] += qi[hh * 32 + 4 * c] * kv.x + qi[hh * 32 + 4 * c + 1] * kv.y + qi[hh * 32 + 4 * c + 2] * kv.z + qi[hh * 32 + 4 * c + 3] * kv.w;
        }
        float sc = 0.f;
#pragma unroll
        for (int hh = 0; hh < 8; ++hh) sc += fmaxf(ds[hh] * 0.17677669529663687f, 0.f) * wi[hh];
        key[j] = f2key(sc);
    }
    __syncthreads();
    if (N <= 256) {
        sel[tid] = tid;
    } else {
        unsigned T = 0u;
        for (int bit = 31; bit >= 0; --bit) {
            const unsigned cand = T | (1u << bit);
            int c = 0;
            for (int j = tid; j < N; j += 256) c += (key[j] >= cand) ? 1 : 0;
            c = block_sum_i(c, redi);
            if (c >= K) T = cand;
        }
        int cg = 0;
        for (int j = tid; j < N; j += 256) cg += (key[j] > T) ? 1 : 0;
        cg = block_sum_i(cg, redi);
        for (int j = tid; j < N; j += 256) if (key[j] > T) { const int pos = atomicAdd(&cnt, 1); sel[pos] = j; }
        __syncthreads();
        if (tid == 0) { int pos = cg; for (int j = 0; j < N && pos < K; ++j) if (key[j] == T) sel[pos++] = j; }
    }
    __syncthreads();
    if (tid < K) {
        const int j = sel[tid];
        const float4* kr = (const float4*)(proj + (size_t)(b * S + j) * ATT_IN + 2048);
        float ds[8];
#pragma unroll
        for (int hh = 0; hh < 8; ++hh) ds[hh] = 0.f;
#pragma unroll 1
        for (int c = 0; c < 16; ++c) {
            const float4 kv = kr[c];
#pragma unroll
            for (int hh = 0; hh < 8; ++hh) ds[hh] += q[hh * 64 + 4 * c] * kv.x + q[hh * 64 + 4 * c + 1] * kv.y + q[hh * 64 + 4 * c + 2] * kv.z + q[hh * 64 + 4 * c + 3] * kv.w;
        }
        const int bk = t5_bucket(j - i);
#pragma unroll
        for (int hh = 0; hh < 8; ++hh) p[hh][tid] = ds[hh] * 0.125f + rel_bias[bk * 12 + 4 + hh];
    }
    __syncthreads();
    {
        const int w = tid >> 6, lane = tid & 63;
        for (int hh = 2 * w; hh < 2 * w + 2; ++hh) {
            float mx = -1e30f;
            for (int t = lane; t < K; t += 64) mx = fmaxf(mx, p[hh][t]);
            mx = wave_max(mx);
            float l = 0.f;
            for (int t = lane; t < K; t += 64) { const float e = expf(p[hh][t] - mx); p[hh][t] = e; l += e; }
            l = wave_sum(l);
            const float r = 1.f / l;
            for (int t = lane; t < K; t += 64) p[hh][t] *= r;
        }
    }
    __syncthreads();
    {
        const int hh = tid >> 5, d0 = (tid & 31) * 2;
        float a0 = 0.f, a1 = 0.f;
        for (int t = 0; t < K; ++t) {
            const float2 vv = *(const float2*)(proj + (size_t)(b * S + sel[t]) * ATT_IN + 2112 + d0);
            a0 += p[hh][t] * vv.x; a1 += p[hh][t] * vv.y;
        }
        float* yo = Y + (size_t)(b * S + i) * D + 512 + hh * 64 + d0;
        yo[0] = a0; yo[1] = a1;
    }
    (void)red;
}

__global__ void __launch_bounds__(512) k_conv(const float* __restrict__ proj, const float* __restrict__ dw_w, const float* __restrict__ dw_b, const float* __restrict__ ln_g,
                                              const float* __restrict__ ln_b, const float* __restrict__ sc_w, float* __restrict__ Y) {
    __shared__ float red[8];
    const int t = blockIdx.x, b = blockIdx.y, c = threadIdx.x;
    float acc = dw_b[c];
    for (int j = 0; j < 31; ++j) {
        const int tt = t - 30 + j;
        if (tt >= 0) {
            const float* row = proj + (size_t)(b * S + tt) * CONV_IN;
            const float ca = row[c], cg = row[512 + c];
            const float u = ca / (1.f + expf(-cg));
            acc += dw_w[j * 512 + c] * u;
        }
    }
    const float mean = block_sum(acc, red) * (1.f / 512.f);
    const float dv = acc - mean;
    const float var = block_sum(dv * dv, red) * (1.f / 512.f);
    const float y = dv * rsqrtf(var + EPS) * ln_g[c] + ln_b[c];
    Y[(size_t)(b * S + t) * D + c] = y / (1.f + expf(-y));
    float z = 0.f;
    for (int j = 0; j < 3; ++j) {
        const int tt = t - 2 + j;
        if (tt >= 0) { const float* row = proj + (size_t)(b * S + tt) * CONV_IN; z += sc_w[j * 512 + c] * row[1536 + c] * row[2048 + c]; }
    }
    z *= proj[(size_t)(b * S + t) * CONV_IN + 1024 + c];
    Y[(size_t)(b * S + t) * D + 512 + c] = z;
}
}

extern "C" void kernel_launch(void* const* d_in, const int* in_sizes, int n_in, void* d_out, int out_size, void* d_ws, size_t ws_size, hipStream_t stream) {
    using namespace v0;
    const float* x = (const float*)d_in[0];
    const float* rel_bias = (const float*)d_in[1];
    const float* norm_g = (const float*)d_in[2];
    const float* w_up = (const float*)d_in[3];
    const float* w_down = (const float*)d_in[4];
    const float* attn_w_in = (const float*)d_in[5];
    const float* attn_w_out = (const float*)d_in[6];
    const float* diff_lambda = (const float*)d_in[7];
    const float* subln_g = (const float*)d_in[8];
    const float* conv_w_in = (const float*)d_in[9];
    const float* conv_w_out = (const float*)d_in[10];
    const float* dw_w = (const float*)d_in[11];
    const float* dw_b = (const float*)d_in[12];
    const float* ln_g = (const float*)d_in[13];
    const float* ln_b = (const float*)d_in[14];
    const float* sc_w = (const float*)d_in[15];
    float* out = (float*)d_out;
    const size_t MiB = 1u << 20;
    float* R0 = (float*)((char*)d_ws);
    float* R1 = (float*)((char*)d_ws + 64 * MiB);
    float* PROJ = R1; float* MIX = R1; float* HID = (float*)((char*)d_ws + 128 * MiB);
    float* Y = R0; float* H = R0;

    for (int layer = 0; layer < 2; ++layer) {
        const float* g = norm_g + (size_t)layer * 4 * D;
        const float* xin = layer == 0 ? x : out;
        k_rmsnorm<<<M / 4, 256, 0, stream>>>(xin, g + 0 * D, H);
        if (layer == 0) {
            k_gemm<0><<<dim3((ATT_IN + 127) / 128, M / 128), 256, 0, stream>>>(H, attn_w_in, PROJ, ATT_IN, D);
            k_diff_attn<<<dim3(S, 4, NB), 256, 0, stream>>>(PROJ, rel_bias, diff_lambda, subln_g, Y);
            k_dsa<<<dim3(S, NB), 256, 0, stream>>>(PROJ, rel_bias, Y);
            k_gemm<0><<<dim3(D / 128, M / 128), 256, 0, stream>>>(Y, attn_w_out, MIX, D, D);
        } else {
            k_gemm<0><<<dim3(CONV_IN / 128, M / 128), 256, 0, stream>>>(H, conv_w_in, PROJ, CONV_IN, D);
            k_conv<<<dim3(S, NB), 512, 0, stream>>>(PROJ, dw_w, dw_b, ln_g, ln_b, sc_w, Y);
            k_gemm<0><<<dim3(D / 128, M / 128), 256, 0, stream>>>(Y, conv_w_out, MIX, D, D);
        }
        k_addnorm<<<M / 4, 256, 0, stream>>>(xin, MIX, g + 1 * D, out);
        k_rmsnorm<<<M / 4, 256, 0, stream>>>(out, g + 2 * D, H);
        const float* wu = w_up + (size_t)layer * D * FF;
        const float* wd = w_down + (size_t)layer * FF * D;
        for (int c = 0; c < 4; ++c) {
            k_gemm<1><<<dim3(FF / 128, 4096 / 128), 256, 0, stream>>>(H + (size_t)c * 4096 * D, wu, HID, FF, D);
            k_gemm<0><<<dim3(D / 128, 4096 / 128), 256, 0, stream>>>(HID, wd, MIX + (size_t)c * 4096 * D, D, FF);
        }
        k_addnorm<<<M / 4, 256, 0, stream>>>(out, MIX, g + 3 * D, out);
    }
}
```
